# Optimizing an MI355X kernel written in HIP

```python
import math
import jax, jax.numpy as jnp
from jax import lax
import numpy as np

D_MODEL = 1024
BATCH = 4
SEQ = 4096
DEPTH = 4

EXPAND = 2
D_MIX = EXPAND * D_MODEL
D_CONV = D_MIX // 2
D_RET = D_MIX - D_CONV
CONV_GROUPS = 8
CONV_K = 3
RET_HEADS = 8
RET_HEAD_DIM = D_RET // RET_HEADS
CHUNK = 128
ROPE_BASE = 10000.0
NORM_EPS = 1e-6
IN_COLS = 4 * D_CONV + 4 * D_RET

kernel_name = "hybrid_shortconv_retention_parallel_heads"


def rms_norm(x, g, eps=NORM_EPS):
    xf = x.astype(jnp.float32)
    y = xf * lax.rsqrt(jnp.mean(xf * xf, axis=-1, keepdims=True) + eps)
    return (y * g.astype(jnp.float32)).astype(x.dtype)


def rotary_tables(positions):
    half = RET_HEAD_DIM // 2
    inv_freq = 1.0 / (ROPE_BASE ** (jnp.arange(half, dtype=jnp.float32) / half))
    ang = positions.astype(jnp.float32)[..., None] * inv_freq
    return jnp.cos(ang)[:, :, None, :], jnp.sin(ang)[:, :, None, :]


def apply_rotary(x, cos, sin):
    xf = x.astype(jnp.float32)
    x1, x2 = jnp.split(xf, 2, axis=-1)
    return jnp.concatenate([x1 * cos - x2 * sin, x2 * cos + x1 * sin], axis=-1).astype(x.dtype)


def causal_depthwise_conv(u, w):
    c = u.shape[-1]
    return lax.conv_general_dilated(
        u, w.astype(u.dtype)[:, None, :], window_strides=(1,), padding=[(CONV_K - 1, 0)],
        dimension_numbers=("NWC", "WIO", "NWC"), feature_group_count=c)


def retention_chunkwise(q, k, v, log_gamma):
    b, s, h, dh = q.shape
    n = s // CHUNK
    q = q.reshape(b, n, CHUNK, h, dh)
    k = k.reshape(b, n, CHUNK, h, dh) * (dh ** -0.5)
    v = v.reshape(b, n, CHUNK, h, dh)
    idx = jnp.arange(CHUNK, dtype=jnp.float32)
    diff = idx[:, None] - idx[None, :]
    causal = diff >= 0
    decay = jnp.where(causal[None], jnp.exp(log_gamma[:, None, None] * jnp.where(causal, diff, 0.0)[None]), 0.0)
    scores = jnp.einsum("bnihd,bnjhd->bnhij", q, k).astype(jnp.float32) * decay
    intra = jnp.einsum("bnhij,bnjhe->bnihe", scores, v.astype(jnp.float32))
    k_w = jnp.exp((CHUNK - 1 - idx)[:, None] * log_gamma[None, :])
    kv = jnp.einsum("bnjhd,bnjhe->nbhde", k.astype(jnp.float32) * k_w[:, :, None],
                    v.astype(jnp.float32))
    chunk_decay = jnp.exp(CHUNK * log_gamma)[None, :, None, None]

    def step(state, kv_n):
        return chunk_decay * state + kv_n, state

    init = jnp.zeros((b, h, dh, dh), jnp.float32)
    _, prev = lax.scan(step, init, kv)
    q_w = jnp.exp((idx + 1.0)[:, None] * log_gamma[None, :])
    cross = jnp.einsum("bnihd,nbhde->bnihe", q.astype(jnp.float32) * q_w[:, :, None], prev)
    return (intra + cross).reshape(b, s, h, dh)


def setup_inputs(seed: int = 0) -> dict:
    key = jax.random.key(seed)
    kx, kp, kn1, kw1, kc, kw2, kn2 = jax.random.split(key, 7)
    x = jax.random.normal(kx, (BATCH, SEQ, D_MODEL), jnp.float32)
    offsets = jax.random.randint(kp, (BATCH, 1), 0, 1024, dtype=jnp.int32)
    positions = offsets + jnp.arange(SEQ, dtype=jnp.int32)[None, :]
    pre_norm = 1.0 + 0.05 * jax.random.normal(kn1, (DEPTH, D_MODEL), jnp.float32)
    w_in = jax.random.normal(kw1, (DEPTH, D_MODEL, IN_COLS), jnp.float32) * D_MODEL ** -0.5
    conv_w = jax.random.normal(kc, (DEPTH, CONV_K, D_CONV), jnp.float32) * CONV_K ** -0.5
    w_out = jax.random.normal(kw2, (DEPTH, D_MIX, D_MODEL), jnp.float32) * D_MIX ** -0.5
    post_norm = 1.0 + 0.05 * jax.random.normal(kn2, (DEPTH, D_MODEL), jnp.float32)
    return {"x": x, "positions": positions, "pre_norm": pre_norm, "w_in": w_in,
            "conv_w": conv_w, "w_out": w_out, "post_norm": post_norm}


def reference(x, positions, pre_norm, w_in, conv_w, w_out, post_norm):
    b, s, _ = x.shape
    cos, sin = rotary_tables(positions)
    log_gamma = jnp.log1p(-jnp.exp2(-5.0 - jnp.arange(RET_HEADS, dtype=jnp.float32)))
    cuts = [D_CONV, 2 * D_CONV, 3 * D_CONV, 4 * D_CONV,
            4 * D_CONV + D_RET, 4 * D_CONV + 2 * D_RET, 4 * D_CONV + 3 * D_RET]
    for layer in range(DEPTH):
        h = rms_norm(x, pre_norm[layer])
        proj = jnp.einsum("bsd,dp->bsp", h, w_in[layer])
        c_b, c_c, c_x, c_z, r_q, r_k, r_v, r_z = jnp.split(proj, cuts, axis=-1)
        y_conv = c_b * causal_depthwise_conv(c_c * c_x, conv_w[layer])
        y_conv = y_conv * jax.nn.silu(c_z)
        q = apply_rotary(r_q.reshape(b, s, RET_HEADS, RET_HEAD_DIM), cos, sin)
        k = apply_rotary(r_k.reshape(b, s, RET_HEADS, RET_HEAD_DIM), cos, sin)
        v = r_v.reshape(b, s, RET_HEADS, RET_HEAD_DIM)
        ret = retention_chunkwise(q, k, v, log_gamma)
        ret = ret * lax.rsqrt(jnp.mean(ret * ret, axis=-1, keepdims=True) + NORM_EPS)
        y_ret = ret.reshape(b, s, D_RET).astype(h.dtype) * jax.nn.silu(r_z)
        mix = jnp.concatenate([y_conv.astype(h.dtype), y_ret], axis=-1)
        out = jnp.einsum("bse,ed->bsd", mix, w_out[layer])
        x = x + rms_norm(out, post_norm[layer]).astype(x.dtype)
    return x
```

```cpp
#include <hip/hip_runtime.h>
#include <cstdint>
#include <cstdio>

typedef unsigned short bf16;
constexpr int BATCH = 4, SEQ = 4096, DM = 1024, M = BATCH * SEQ, NCOL = 8192, DMIX = 2048, DEPTH = 4, NH = 8, HD = 128, CH = 128, NCH = SEQ / CH;
constexpr float EPS = 1e-6f;
constexpr size_t MiB = 1u << 20;
constexpr size_t WS_XB = 0, WS_U = 32 * MiB, WS_G2 = 64 * MiB, WS_QT = 96 * MiB, WS_KT = 128 * MiB, WS_V = 160 * MiB, WS_ZR = 192 * MiB, WS_MIX = 224 * MiB,
                 WS_SP = 288 * MiB, WS_COS = 320 * MiB, WS_SIN = 324 * MiB, WS_SSQ = 328 * MiB, WS_OUT = 336 * MiB;

__device__ __forceinline__ float bf2f(bf16 v) { return __uint_as_float((unsigned)v << 16); }
__device__ __forceinline__ bf16 f2bf(float f) { unsigned u = __float_as_uint(f); return (bf16)((u + 0x7fffu + ((u >> 16) & 1u)) >> 16); }
__device__ __forceinline__ float wave_sum(float v) {
#pragma unroll
    for (int o = 1; o < 64; o <<= 1) v += __shfl_xor(v, o);
    return v;
}
__device__ __forceinline__ float silu(float z) { return z / (1.f + __expf(-z)); }
__device__ __forceinline__ float gamma_log2(int h) { return log2f(1.f - exp2f(-5.f - (float)h)); }

__global__ void k_tables(const int* pos, float* COS, float* SIN) {
    const int idx = blockIdx.x * 256 + threadIdx.x; if (idx >= M * 64) return;
    const int m = idx >> 6, i = idx & 63;
    const float inv = (float)(1.0 / pow(10000.0, (double)i / 64.0));
    const float ang = (float)pos[m] * inv;
    COS[idx] = (float)cos((double)ang); SIN[idx] = (float)sin((double)ang);
}
__global__ void k_rows0(const float* x, bf16* XB, float* SSQ) {
    const int m = blockIdx.x * 4 + (threadIdx.x >> 6), lane = threadIdx.x & 63;
    const float4* xr = (const float4*)(x + (size_t)m * DM) + lane;
#pragma unroll
    for (int j = 0; j < 4; ++j) { const float4 v = xr[64 * j]; const float s = wave_sum(v.x * v.x + v.y * v.y + v.z * v.z + v.w * v.w);
        if (lane == 0) SSQ[m * 4 + j] = s;
        bf16* o = XB + (size_t)m * DM + 256 * j + lane * 4; o[0] = f2bf(v.x); o[1] = f2bf(v.y); o[2] = f2bf(v.z); o[3] = f2bf(v.w); }
}
__global__ void __launch_bounds__(256) k_gemm1(const float* x, const float* SSQ, const float* g, const float* w, const float* COS, const float* SIN,
                                               bf16* U, bf16* G2, bf16* QT, bf16* KT, bf16* V, bf16* ZR) {
    __shared__ float As[16][64]; __shared__ float Bs[16][128];
    const int pt = blockIdx.x & 63, mt = blockIdx.x >> 6, tid = threadIdx.x, tx = tid & 15, ty = tid >> 4;
    int type, colA0, colB0;
    if (pt < 16) { type = 0; colA0 = 1024 + pt * 64; colB0 = 2048 + pt * 64; }
    else if (pt < 32) { type = 1; colA0 = (pt - 16) * 64; colB0 = 3072 + (pt - 16) * 64; }
    else if (pt < 40) { type = 2; colA0 = 4096 + (pt - 32) * 128; colB0 = colA0 + 64; }
    else if (pt < 48) { type = 3; colA0 = 5120 + (pt - 40) * 128; colB0 = colA0 + 64; }
    else { type = 4; colA0 = 6144 + (pt - 48) * 64; colB0 = 7168 + (pt - 48) * 64; }
    float a[4][4] = {}, b[4][4] = {};
    const int m0 = mt * 64;
    for (int k0 = 0; k0 < DM; k0 += 16) {
        { const int r = tid >> 2, k4 = (tid & 3) * 4; const float4 xv = *(const float4*)(x + (size_t)(m0 + r) * DM + k0 + k4); const float4 gv = *(const float4*)(g + k0 + k4);
          As[k4 + 0][r] = xv.x * gv.x; As[k4 + 1][r] = xv.y * gv.y; As[k4 + 2][r] = xv.z * gv.z; As[k4 + 3][r] = xv.w * gv.w; }
        { const int k = tid >> 4, c8 = (tid & 15) * 8; const int col = (c8 < 64) ? colA0 + c8 : colB0 + c8 - 64; const float* wp = w + (size_t)(k0 + k) * NCOL + col;
          *(float4*)&Bs[k][c8] = *(const float4*)wp; *(float4*)&Bs[k][c8 + 4] = *(const float4*)(wp + 4); }
        __syncthreads();
#pragma unroll
        for (int k = 0; k < 16; ++k) { float av[4], bA[4], bB[4];
#pragma unroll
            for (int i = 0; i < 4; ++i) { av[i] = As[k][ty * 4 + i]; bA[i] = Bs[k][tx * 4 + i]; bB[i] = Bs[k][64 + tx * 4 + i]; }
#pragma unroll
            for (int i = 0; i < 4; ++i)
#pragma unroll
                for (int j = 0; j < 4; ++j) { a[i][j] += av[i] * bA[j]; b[i][j] += av[i] * bB[j]; } }
        __syncthreads();
    }
#pragma unroll
    for (int i = 0; i < 4; ++i) {
        const int m = m0 + ty * 4 + i; const float rs = rsqrtf((SSQ[m * 4] + SSQ[m * 4 + 1] + SSQ[m * 4 + 2] + SSQ[m * 4 + 3]) * (1.f / DM) + EPS);
#pragma unroll
        for (int j = 0; j < 4; ++j) {
            const int p = tx * 4 + j; const float va = a[i][j] * rs, vb = b[i][j] * rs;
            if (type == 0) U[(size_t)m * DM + pt * 64 + p] = f2bf(va * vb);
            else if (type == 1) G2[(size_t)m * DM + (pt - 16) * 64 + p] = f2bf(va * silu(vb));
            else if (type == 4) { V[(size_t)m * DM + (pt - 48) * 64 + p] = f2bf(va); ZR[(size_t)m * DM + (pt - 48) * 64 + p] = f2bf(silu(vb)); }
            else { const int h = (type == 2) ? pt - 32 : pt - 40; const float c = COS[m * 64 + p], s = SIN[m * 64 + p];
                const float e = (float)((m & (CH - 1)) + 1) * gamma_log2(h);
                const float sc = (type == 2) ? exp2f(e) : exp2f(-e) * 0.08838834764831845f;
                bf16* o = ((type == 2) ? QT : KT) + (size_t)m * DM + h * HD + p;
                o[0] = f2bf((va * c - vb * s) * sc); o[64] = f2bf((vb * c + va * s) * sc); }
        }
    }
}
__global__ void k_scan(const bf16* KT, const bf16* V, bf16* SP) {
    const int bh = blockIdx.x >> 6, idx = (blockIdx.x & 63) * 256 + threadIdx.x, e = idx >> 7, d = idx & 127, b = bh >> 3, h = bh & 7;
    const float g128 = exp2f(128.f * gamma_log2(h));
    float S = 0.f;
    for (int n = 0; n < NCH; ++n) {
        SP[((size_t)(bh * NCH + n) * HD + e) * HD + d] = f2bf(S);
        const size_t m0 = (size_t)b * SEQ + n * CH; float acc = 0.f;
        for (int j = 0; j < CH; ++j) acc += bf2f(KT[(m0 + j) * DM + h * HD + d]) * bf2f(V[(m0 + j) * DM + h * HD + e]);
        S = g128 * (S + acc);
    }
}
__global__ void __launch_bounds__(128) k_ret(const bf16* QT, const bf16* KT, const bf16* V, const bf16* ZR, const bf16* SP, bf16* MIX) {
    __shared__ float sc[128 * 128];
    const int item = blockIdx.x, n = item & 31, bh = item >> 5, b = bh >> 3, h = bh & 7, i = threadIdx.x;
    const size_t m0 = (size_t)b * SEQ + n * CH; const bf16* qrow = QT + (m0 + i) * DM + h * HD;
    for (int j = 0; j < CH; ++j) { float s = 0.f;
        if (j <= i) { const bf16* krow = KT + (m0 + j) * DM + h * HD; for (int d = 0; d < HD; ++d) s += bf2f(qrow[d]) * bf2f(krow[d]); }
        sc[j * 128 + i] = s; }
    const bf16* sp = SP + (size_t)(bh * NCH + n) * HD * HD;
    float ss = 0.f;
    for (int pass = 0; pass < 2; ++pass) {
        const float rn = rsqrtf(ss * (1.f / HD) + EPS);
        for (int e = 0; e < HD; ++e) { float o = 0.f;
            for (int j = 0; j <= i; ++j) o += sc[j * 128 + i] * bf2f(V[(m0 + j) * DM + h * HD + e]);
            for (int d = 0; d < HD; ++d) o += bf2f(qrow[d]) * bf2f(sp[e * HD + d]);
            if (pass == 0) ss += o * o; else MIX[(m0 + i) * DMIX + DM + h * HD + e] = f2bf(o * rn * bf2f(ZR[(m0 + i) * DM + h * HD + e])); }
    }
}
__global__ void k_conv(const bf16* U, const bf16* G2, const float* cw, bf16* MIX) {
    const size_t idx = (size_t)blockIdx.x * 256 + threadIdx.x; const int m = (int)(idx >> 10), c = (int)(idx & 1023), t = m & (SEQ - 1);
    float y = cw[2 * DM + c] * bf2f(U[idx]);
    if (t >= 1) y += cw[DM + c] * bf2f(U[idx - DM]);
    if (t >= 2) y += cw[c] * bf2f(U[idx - 2 * DM]);
    MIX[(size_t)m * DMIX + c] = f2bf(y * bf2f(G2[idx]));
}
__global__ void __launch_bounds__(256) k_gemm2(const bf16* MIX, const float* w, float* OUT) {
    __shared__ float As[16][64]; __shared__ float Bs[16][64];
    const int nt = blockIdx.x & 15, mt = blockIdx.x >> 4, tid = threadIdx.x, tx = tid & 15, ty = tid >> 4, m0 = mt * 64, n0 = nt * 64;
    float a[4][4] = {};
    for (int k0 = 0; k0 < DMIX; k0 += 16) {
        { const int r = tid >> 2, k4 = (tid & 3) * 4; const bf16* p = MIX + (size_t)(m0 + r) * DMIX + k0 + k4;
          As[k4][r] = bf2f(p[0]); As[k4 + 1][r] = bf2f(p[1]); As[k4 + 2][r] = bf2f(p[2]); As[k4 + 3][r] = bf2f(p[3]); }
        { const int k = tid >> 4, c4 = (tid & 15) * 4; *(float4*)&Bs[k][c4] = *(const float4*)(w + (size_t)(k0 + k) * DM + n0 + c4); }
        __syncthreads();
#pragma unroll
        for (int k = 0; k < 16; ++k) { float av[4], bv[4];
#pragma unroll
            for (int i = 0; i < 4; ++i) { av[i] = As[k][ty * 4 + i]; bv[i] = Bs[k][tx * 4 + i]; }
#pragma unroll
            for (int i = 0; i < 4; ++i)
#pragma unroll
                for (int j = 0; j < 4; ++j) a[i][j] += av[i] * bv[j]; }
        __syncthreads();
    }
#pragma unroll
    for (int i = 0; i < 4; ++i) *(float4*)(OUT + (size_t)(m0 + ty * 4 + i) * DM + n0 + tx * 4) = make_float4(a[i][0], a[i][1], a[i][2], a[i][3]);
}
__global__ void k_post(const float* xi, const float* OUT, const float* g, float* xo, bf16* XB, float* SSQ) {
    const int m = blockIdx.x * 4 + (threadIdx.x >> 6), lane = threadIdx.x & 63;
    const float4* orow = (const float4*)(OUT + (size_t)m * DM) + lane; float4 v[4]; float s = 0.f;
#pragma unroll
    for (int j = 0; j < 4; ++j) { v[j] = orow[64 * j]; s += v[j].x * v[j].x + v[j].y * v[j].y + v[j].z * v[j].z + v[j].w * v[j].w; }
    const float rn = rsqrtf(wave_sum(s) * (1.f / DM) + EPS);
#pragma unroll
    for (int j = 0; j < 4; ++j) { const float4 xv = ((const float4*)(xi + (size_t)m * DM) + lane)[64 * j]; const float4 gv = ((const float4*)g + lane)[64 * j];
        float4 o; o.x = xv.x + v[j].x * rn * gv.x; o.y = xv.y + v[j].y * rn * gv.y; o.z = xv.z + v[j].z * rn * gv.z; o.w = xv.w + v[j].w * rn * gv.w;
        ((float4*)(xo + (size_t)m * DM) + lane)[64 * j] = o;
        const float q = wave_sum(o.x * o.x + o.y * o.y + o.z * o.z + o.w * o.w); if (lane == 0) SSQ[m * 4 + j] = q;
        bf16* ob = XB + (size_t)m * DM + 256 * j + lane * 4; ob[0] = f2bf(o.x); ob[1] = f2bf(o.y); ob[2] = f2bf(o.z); ob[3] = f2bf(o.w); }
}

extern "C" void kernel_launch(void* const* d_in, const int* in_sizes, int n_in, void* d_out, int out_size, void* d_ws, size_t ws_size, hipStream_t stream) {
    const float* x = (const float*)d_in[0]; const int* pos = (const int*)d_in[1]; const float* pre = (const float*)d_in[2]; const float* w_in = (const float*)d_in[3];
    const float* cw = (const float*)d_in[4]; const float* w_out = (const float*)d_in[5]; const float* post = (const float*)d_in[6];
    unsigned char* ws = (unsigned char*)d_ws; float* out = (float*)d_out;
    bf16 *XB = (bf16*)(ws + WS_XB), *U = (bf16*)(ws + WS_U), *G2 = (bf16*)(ws + WS_G2), *QT = (bf16*)(ws + WS_QT), *KT = (bf16*)(ws + WS_KT), *V = (bf16*)(ws + WS_V), *ZR = (bf16*)(ws + WS_ZR),
         *MIX = (bf16*)(ws + WS_MIX), *SP = (bf16*)(ws + WS_SP);
    float *COS = (float*)(ws + WS_COS), *SIN = (float*)(ws + WS_SIN), *SSQ = (float*)(ws + WS_SSQ), *OUT = (float*)(ws + WS_OUT);
    k_tables<<<M * 64 / 256, 256, 0, stream>>>(pos, COS, SIN);
    k_rows0<<<M / 4, 256, 0, stream>>>(x, XB, SSQ);
    for (int l = 0; l < DEPTH; ++l) {
        const float* xi = l == 0 ? x : out;
        k_gemm1<<<(M / 64) * 64, 256, 0, stream>>>(xi, SSQ, pre + l * DM, w_in + (size_t)l * DM * NCOL, COS, SIN, U, G2, QT, KT, V, ZR);
        k_scan<<<BATCH * NH * 64, 256, 0, stream>>>(KT, V, SP);
        k_ret<<<BATCH * NH * NCH, 128, 0, stream>>>(QT, KT, V, ZR, SP, MIX);
        k_conv<<<M * DM / 256, 256, 0, stream>>>(U, G2, cw + (size_t)l * 3 * DM, MIX);
        k_gemm2<<<(M / 64) * 16, 256, 0, stream>>>(MIX, w_out + (size_t)l * DMIX * DM, OUT);
        k_post<<<M / 4, 256, 0, stream>>>(xi, OUT, post + l * DM, out, XB, SSQ);
    }
}
```
